# Optimizing an MI355X kernel written in HIP

```python
import jax, jax.numpy as jnp
from jax import lax
import numpy as np

D_MODEL = 1024
BATCH = 2
SEQ = 8192
DEPTH = 2

D_MIX = D_MODEL
POOL_WIDTH = D_MIX // 2
POOL_WINDOWS = (2, 4, 8, 16)
POOL_GROUPS = len(POOL_WINDOWS)
POOL_GROUP_DIM = POOL_WIDTH // POOL_GROUPS
SGU_WIDTH = D_MIX - POOL_WIDTH
SGU_HEADS = 4
SGU_HEAD_DIM = SGU_WIDTH // SGU_HEADS
CHUNK = 128
EVEN_IN = POOL_WIDTH + 2 * SGU_WIDTH
CONV_WIDTH = 3
CONV_DIM = D_MIX
D_FF = 4 * D_MODEL
PLE_DIM = 256
LN_EPS = 1e-5
N_EVEN = (DEPTH + 1) // 2
N_ODD = DEPTH // 2
DEEPNORM_ALPHA = (2.0 * DEPTH) ** 0.25
DEEPNORM_BETA = (8.0 * DEPTH) ** -0.25

kernel_name = "hybrid_pool_sgu_shortconv_deepnorm_trunk"


def layer_norm(x, g, b):
    xf = x.astype(jnp.float32)
    mu = jnp.mean(xf, axis=-1, keepdims=True)
    var = jnp.mean(jnp.square(xf - mu), axis=-1, keepdims=True)
    y = (xf - mu) * lax.rsqrt(var + LN_EPS)
    return (y * g.astype(jnp.float32) + b.astype(jnp.float32)).astype(x.dtype)


def pool_mixer(a, pool_w, pool_scale):
    bsz, s, _ = a.shape
    ag = a.reshape(bsz, s, POOL_GROUPS, POOL_GROUP_DIM)
    t = jnp.arange(s)
    outs = []
    for g, w in enumerate(POOL_WINDOWS):
        xg = ag[:, :, g].astype(jnp.float32)
        cs = jnp.cumsum(xg, axis=1)
        lag = jnp.pad(cs, ((0, 0), (w, 0), (0, 0)))[:, :s]
        cnt = jnp.minimum(t + 1, w).astype(jnp.float32)[None, :, None]
        pooled = (cs - lag) / cnt - xg
        outs.append(jnp.einsum('bsc,cd->bsd', pooled.astype(a.dtype), pool_w[g]))
    return jnp.concatenate(outs, axis=-1) * pool_scale


def spatial_gating(u, v, ln_g, ln_b, w_s, b_s):
    bsz, s, _ = u.shape
    vn = layer_norm(v, ln_g, ln_b)
    vc = vn.reshape(bsz, s // CHUNK, CHUNK, SGU_HEADS, SGU_HEAD_DIM)
    mask = jnp.tril(jnp.ones((CHUNK, CHUNK), w_s.dtype))
    mixed = jnp.einsum('hts,bnshc->bnthc', w_s * mask, vc) + b_s.T[None, None, :, :, None]
    return u * mixed.reshape(bsz, s, SGU_WIDTH)


def short_conv_mixer(x, w_in, conv_w, w_out):
    proj = jnp.einsum('bsd,de->bse', x, w_in)
    gate_b, gate_c, h = jnp.split(proj, 3, axis=-1)
    z = gate_c * h
    zp = jnp.pad(z, ((0, 0), (CONV_WIDTH - 1, 0), (0, 0)))
    s = x.shape[1]
    conv = sum(conv_w[k] * zp[:, k:k + s] for k in range(CONV_WIDTH))
    return jnp.einsum('bse,ed->bsd', gate_b * conv, w_out)


def setup_inputs(seed: int = 0) -> dict:
    key = jax.random.key(seed)
    ks = jax.random.split(key, 24)
    f32 = jnp.float32
    nrm = lambda k, shape, scale: jax.random.normal(k, shape, f32) * scale
    return {
        "x": nrm(ks[0], (BATCH, SEQ, D_MODEL), 1.0),
        "p": nrm(ks[1], (DEPTH, BATCH, SEQ, PLE_DIM), 1.0),
        "ev_w_in": nrm(ks[2], (N_EVEN, D_MODEL, EVEN_IN), D_MODEL ** -0.5),
        "ev_pool_w": nrm(ks[3], (N_EVEN, POOL_GROUPS, POOL_GROUP_DIM, POOL_GROUP_DIM), POOL_GROUP_DIM ** -0.5),
        "ev_pool_scale": 1.0 + nrm(ks[4], (N_EVEN, POOL_WIDTH), 0.05),
        "ev_sgu_ln_g": 1.0 + nrm(ks[5], (N_EVEN, SGU_WIDTH), 0.05),
        "ev_sgu_ln_b": nrm(ks[6], (N_EVEN, SGU_WIDTH), 0.02),
        "ev_sgu_w": nrm(ks[7], (N_EVEN, SGU_HEADS, CHUNK, CHUNK), CHUNK ** -0.5),
        "ev_sgu_b": 1.0 + nrm(ks[8], (N_EVEN, SGU_HEADS, CHUNK), 0.01),
        "ev_w_out": nrm(ks[9], (N_EVEN, D_MIX, D_MODEL), D_MIX ** -0.5 * DEEPNORM_BETA),
        "od_w_in": nrm(ks[10], (N_ODD, D_MODEL, 3 * CONV_DIM), D_MODEL ** -0.5),
        "od_conv_w": nrm(ks[11], (N_ODD, CONV_WIDTH, CONV_DIM), CONV_WIDTH ** -0.5),
        "od_w_out": nrm(ks[12], (N_ODD, CONV_DIM, D_MODEL), CONV_DIM ** -0.5 * DEEPNORM_BETA),
        "ln1_g": 1.0 + nrm(ks[13], (DEPTH, D_MODEL), 0.05),
        "ln1_b": nrm(ks[14], (DEPTH, D_MODEL), 0.02),
        "ffn_w1": nrm(ks[15], (DEPTH, D_MODEL, D_FF), D_MODEL ** -0.5),
        "ffn_w2": nrm(ks[16], (DEPTH, D_FF, D_MODEL), D_FF ** -0.5 * DEEPNORM_BETA),
        "ln2_g": 1.0 + nrm(ks[17], (DEPTH, D_MODEL), 0.05),
        "ln2_b": nrm(ks[18], (DEPTH, D_MODEL), 0.02),
        "ple_gate_w": nrm(ks[19], (DEPTH, D_MODEL, D_MODEL), D_MODEL ** -0.5),
        "ple_w": nrm(ks[20], (DEPTH, PLE_DIM, D_MODEL), PLE_DIM ** -0.5),
    }


def reference(x, p, ev_w_in, ev_pool_w, ev_pool_scale, ev_sgu_ln_g, ev_sgu_ln_b,
              ev_sgu_w, ev_sgu_b, ev_w_out, od_w_in, od_conv_w, od_w_out,
              ln1_g, ln1_b, ffn_w1, ffn_w2, ln2_g, ln2_b, ple_gate_w, ple_w):
    for i in range(DEPTH):
        j = i // 2
        if i % 2 == 0:
            proj = jnp.einsum('bsd,de->bse', x, ev_w_in[j])
            a = proj[..., :POOL_WIDTH]
            u = proj[..., POOL_WIDTH:POOL_WIDTH + SGU_WIDTH]
            v = proj[..., POOL_WIDTH + SGU_WIDTH:]
            y_a = pool_mixer(a, ev_pool_w[j], ev_pool_scale[j])
            y_b = spatial_gating(u, v, ev_sgu_ln_g[j], ev_sgu_ln_b[j], ev_sgu_w[j], ev_sgu_b[j])
            mix = jnp.einsum('bse,ed->bsd', jnp.concatenate([y_a, y_b], axis=-1), ev_w_out[j])
        else:
            mix = short_conv_mixer(x, od_w_in[j], od_conv_w[j], od_w_out[j])
        x = layer_norm(DEEPNORM_ALPHA * x + mix, ln1_g[i], ln1_b[i])
        hid = jnp.square(jax.nn.relu(jnp.einsum('bsd,df->bsf', x, ffn_w1[i])))
        x = layer_norm(DEEPNORM_ALPHA * x + jnp.einsum('bsf,fd->bsd', hid, ffn_w2[i]), ln2_g[i], ln2_b[i])
        gate = jax.nn.sigmoid(jnp.einsum('bsd,de->bse', x, ple_gate_w[i]))
        x = x + gate * jnp.einsum('bsk,kd->bsd', p[i], ple_w[i])
    return x
```

```cpp
#include <hip/hip_runtime.h>
#include <cstdio>
#include <cstdint>
namespace pg8 {
#define PG8_LAS __attribute__((address_space(3)))
typedef unsigned short bf16_t;
typedef short bf16x8 __attribute__((ext_vector_type(8)));
typedef float f32x4 __attribute__((ext_vector_type(4)));
typedef unsigned u32x4 __attribute__((ext_vector_type(4)));
constexpr int BM = 256, BK = 64, HALF = 128, HTB = HALF * BK * 2  , STAGE_BYTES = 8 * HTB, NXCD = 8, WGM = 8;

__host__ __device__ __forceinline__ int lds_byte(int r, int c) { const int st = (r >> 4) * 2 + (c >> 5), rr = r & 15, cc = c & 31, ob = rr * 64 + cc * 2; return st * 1024 + (ob ^ (((ob >> 9) & 1) << 5)); }
__host__ __device__ __forceinline__ void stage_rc(int b, int& R, int& C) { const int st = b / 1024, sb = b % 1024, swz = sb ^ (((sb >> 9) & 1) << 5); R = (st >> 1) * 16 + swz / 64; C = (st & 1) * 32 + (swz % 64) / 2; }
__host__ __device__ __forceinline__ int perm32(int rho) { const int n = rho >> 4, i = rho & 15; return 8 * (i >> 2) + 4 * n + (i & 3); }

struct Unit { int pm, pn; };
struct Gemm { const bf16_t* A; const bf16_t* Bt; int M, N, K; };

struct StaticOrder {
    int nM, nN, nwg, G, c;
    __host__ __device__ void init(int M, int N, int G_, int c_) { nM = M / BM; nN = N / BM; nwg = nM * nN; G = G_; c = c_; }
    __host__ __device__ bool next(int i, Unit& u) const {
        const long L = (long)i * G + c; if (L >= nwg) return false;
        int wgid = (int)L; { const int q = nwg / NXCD, r = nwg % NXCD, xcd = wgid % NXCD, off = wgid / NXCD; wgid = (xcd < r ? xcd * (q + 1) : r * (q + 1) + (xcd - r) * q) + off; }
        const int nig = WGM * nN, gid = wgid / nig, fm = gid * WGM, gsz = (nM - fm) < WGM ? (nM - fm) : WGM;
        u.pm = fm + ((wgid % nig) % gsz); u.pn = (wgid % nig) / gsz; return true;
    }
    __device__ __forceinline__ void a_ready(const Unit&) const {}
    __device__ __forceinline__ void done(const Unit&) const {}
};

__device__ __forceinline__ unsigned cvt_pk_bf16(float lo, float hi) { unsigned r; asm volatile("v_cvt_pk_bf16_f32 %0, %1, %2" : "=v"(r) : "v"(lo), "v"(hi)); return r; }
typedef float f32x2 __attribute__((ext_vector_type(2)));
typedef unsigned u32x2 __attribute__((ext_vector_type(2)));
__device__ __forceinline__ float bf_lo(unsigned w) { return __uint_as_float(w << 16); }
__device__ __forceinline__ float bf_hi(unsigned w) { return __uint_as_float(w & 0xffff0000u); }

template <int ACT> struct EpiBf16 {
    static constexpr bool PERM = true, AFTER_DRAIN = false;
    bf16_t* O; int ldc;
    __device__ __forceinline__ void operator()(const f32x4 (&acc)[2][2][4][2], const Unit& u, int wr, int wc, int fr, int fq) const {
        const int row0 = u.pm * BM + wr * 64 + fr, col0 = u.pn * BM + wc * 32 + 8 * fq;
#pragma unroll
        for (int ai = 0; ai < 2; ++ai)
#pragma unroll
            for (int m = 0; m < 4; ++m) { bf16_t* rowp = O + (size_t)(row0 + ai * HALF + m * 16) * ldc + col0;
#pragma unroll
                for (int bj = 0; bj < 2; ++bj) { f32x4 v0 = acc[ai][bj][m][0], v1 = acc[ai][bj][m][1];
                    if (ACT == 2) { v0 = __builtin_elementwise_max(v0, (f32x4){0.f, 0.f, 0.f, 0.f}); v1 = __builtin_elementwise_max(v1, (f32x4){0.f, 0.f, 0.f, 0.f}); v0 = v0 * v0; v1 = v1 * v1; }
                    u32x4 w; w.x = cvt_pk_bf16(v0[0], v0[1]); w.y = cvt_pk_bf16(v0[2], v0[3]); w.z = cvt_pk_bf16(v1[0], v1[1]); w.w = cvt_pk_bf16(v1[2], v1[3]);
                    *(u32x4*)(rowp + bj * HALF) = w; } }
    }
};
struct EpiCH {
    static constexpr bool PERM = true, AFTER_DRAIN = false;
    bf16_t* Z; bf16_t* Bg; int ldc;
    __device__ __forceinline__ void operator()(const f32x4 (&acc)[2][2][4][2], const Unit& u, int wr, int wc, int fr, int fq) const {
        const int row0 = u.pm * BM + wr * 64 + fr;
        if (u.pn < 8) {
            const int col0 = u.pn * HALF + wc * 32 + 8 * fq;
#pragma unroll
            for (int ai = 0; ai < 2; ++ai)
#pragma unroll
                for (int m = 0; m < 4; ++m) { const f32x4 v0 = acc[ai][0][m][0] * acc[ai][1][m][0], v1 = acc[ai][0][m][1] * acc[ai][1][m][1];
                    u32x4 w; w.x = cvt_pk_bf16(v0[0], v0[1]); w.y = cvt_pk_bf16(v0[2], v0[3]); w.z = cvt_pk_bf16(v1[0], v1[1]); w.w = cvt_pk_bf16(v1[2], v1[3]);
                    *(u32x4*)(Z + (size_t)(row0 + ai * HALF + m * 16) * ldc + col0) = w; }
        } else {
            const int col0 = (u.pn - 8) * BM + wc * 32 + 8 * fq;
#pragma unroll
            for (int ai = 0; ai < 2; ++ai)
#pragma unroll
                for (int m = 0; m < 4; ++m) { bf16_t* rowp = Bg + (size_t)(row0 + ai * HALF + m * 16) * ldc + col0;
#pragma unroll
                    for (int bj = 0; bj < 2; ++bj) { const f32x4 v0 = acc[ai][bj][m][0], v1 = acc[ai][bj][m][1];
                        u32x4 w; w.x = cvt_pk_bf16(v0[0], v0[1]); w.y = cvt_pk_bf16(v0[2], v0[3]); w.z = cvt_pk_bf16(v1[0], v1[1]); w.w = cvt_pk_bf16(v1[2], v1[3]);
                        *(u32x4*)(rowp + bj * HALF) = w; } }
        }
    }
};
struct EpiRes {
    static constexpr bool PERM = false, AFTER_DRAIN = false;
    const float* base; float* out; int ldc; float alpha;
    __device__ __forceinline__ void operator()(const f32x4 (&acc)[2][2][4][2], const Unit& u, int wr, int wc, int fr, int fq) const {
        const int row0 = u.pm * BM + wr * 64 + fr, col0 = u.pn * BM + wc * 32 + 4 * fq;
#pragma unroll
        for (int ai = 0; ai < 2; ++ai)
#pragma unroll
            for (int m = 0; m < 4; ++m) { const size_t off = (size_t)(row0 + ai * HALF + m * 16) * ldc + col0;
#pragma unroll
                for (int bj = 0; bj < 2; ++bj)
#pragma unroll
                    for (int n = 0; n < 2; ++n) { const f32x4 bs = *(const f32x4*)(base + off + bj * HALF + n * 16); *(f32x4*)(out + off + bj * HALF + n * 16) = bs * alpha + acc[ai][bj][m][n]; }
                if (m & 1) asm volatile("" ::: "memory"); }
    }
};
struct EpiGate {
    static constexpr bool PERM = false, AFTER_DRAIN = false;
    const float* xf; const bf16_t* pp; float* out; bf16_t* xb; int ldc;
    __device__ __forceinline__ void operator()(const f32x4 (&acc)[2][2][4][2], const Unit& u, int wr, int wc, int fr, int fq) const {
        const int row0 = u.pm * BM + wr * 64 + fr, col0 = u.pn * BM + wc * 32 + 4 * fq;
#pragma unroll
        for (int ai = 0; ai < 2; ++ai)
#pragma unroll
            for (int m = 0; m < 4; ++m) { const size_t off = (size_t)(row0 + ai * HALF + m * 16) * ldc + col0;
#pragma unroll
                for (int bj = 0; bj < 2; ++bj)
#pragma unroll
                    for (int n = 0; n < 2; ++n) { const size_t o2 = off + bj * HALF + n * 16;
                        const f32x4 bs = *(const f32x4*)(xf + o2); const u32x2 pw = *(const u32x2*)(pp + o2); const f32x4 a = acc[ai][bj][m][n];
                        f32x4 g;
#pragma unroll
                        for (int e = 0; e < 4; ++e) g[e] = __builtin_amdgcn_rcpf(1.0f + __builtin_amdgcn_exp2f(a[e] * -1.44269504089f));
                        f32x4 o; o[0] = bs[0] + g[0] * bf_lo(pw.x); o[1] = bs[1] + g[1] * bf_hi(pw.x); o[2] = bs[2] + g[2] * bf_lo(pw.y); o[3] = bs[3] + g[3] * bf_hi(pw.y);
                        *(f32x4*)(out + o2) = o;
                        if (xb) { u32x2 w; w.x = cvt_pk_bf16(o[0], o[1]); w.y = cvt_pk_bf16(o[2], o[3]); *(u32x2*)(xb + o2) = w; } }
                if (m & 1) asm volatile("" ::: "memory"); }
    }
};

template <class Epi, class Sched, bool ALIGN_EPI = false, bool SP2 = false>
__device__ __forceinline__ void gemm_phase(PG8_LAS unsigned char* lds, const Gemm g, const Sched& S, const Epi& E) {
    const int tid = threadIdx.x, wid = __builtin_amdgcn_readfirstlane(tid >> 6), lane = tid & 63, wr = wid >> 2, wc = wid & 3, fr = lane & 15, fq = lane >> 4;
    const int K = g.K, nt = K / BK;
    unsigned voffA[2], voffB[2];
#pragma unroll
    for (int i = 0; i < 2; ++i) { int R, C; stage_rc(tid * 16 + i * 8192, R, C); const int Rb = Epi::PERM ? ((R & ~31) + perm32(R & 31)) : R;
        voffA[i] = (unsigned)(R * K + C) * 2u; voffB[i] = (unsigned)(Rb * K + C) * 2u; }
    const size_t kstep = (size_t)(BK * 2);
    const size_t hstep = (size_t)HALF * K * 2;
    const size_t tstep = 2 * hstep;
    const unsigned ldsw = (unsigned)wid * 1024u;
    const int aoff = lds_byte(wr * 64 + fr, fq * 8), boff = lds_byte(wc * 32 + fr, fq * 8);
#define PG8_SA(b, h) (((b) * 2 + (h)) * HTB)
#define PG8_SB(b, h) ((4 + (b) * 2 + (h)) * HTB)
#define PG8_STAGE(bufoff, gbase, voff) do { _Pragma("unroll") for (int _i = 0; _i < 2; ++_i) \
        __builtin_amdgcn_global_load_lds((const unsigned*)((const char*)(gbase) + (voff)[_i]), (PG8_LAS unsigned*)(lds + (bufoff) + ldsw + _i * 8192), 16, 0, 0); } while (0)
#define PG8_LDA(dst, b, h) do { _Pragma("unroll") for (int m = 0; m < 4; ++m) _Pragma("unroll") for (int k = 0; k < 2; ++k) dst[m][k] = *(const PG8_LAS bf16x8*)(lds + PG8_SA(b, h) + aoff + m * 2048 + k * 1024); } while (0)
#define PG8_LDB(dst, b, h) do { _Pragma("unroll") for (int n = 0; n < 2; ++n) _Pragma("unroll") for (int k = 0; k < 2; ++k) dst[n][k] = *(const PG8_LAS bf16x8*)(lds + PG8_SB(b, h) + boff + n * 2048 + k * 1024); } while (0)
#define PG8_MMA(ai, bj, At, Bt) do { __builtin_amdgcn_s_setprio(1); _Pragma("unroll") for (int m = 0; m < 4; ++m) _Pragma("unroll") for (int n = 0; n < 2; ++n) _Pragma("unroll") for (int k = 0; k < 2; ++k) \
        acc[ai][bj][m][n] = __builtin_amdgcn_mfma_f32_16x16x32_bf16(Bt[n][k], At[m][k], acc[ai][bj][m][n], 0, 0, 0); __builtin_amdgcn_s_setprio(0); } while (0)
#define PG8_WAIT_V(n) asm volatile("s_waitcnt vmcnt(" #n ")" ::: "memory")
#define PG8_WAIT_L(n) asm volatile("s_waitcnt lgkmcnt(" #n ")" ::: "memory")
#define PG8_BAR __builtin_amdgcn_s_barrier()
#define PG8_SCHED __builtin_amdgcn_sched_barrier(0)
    Unit cur, nxt; int ui = 0;
    if (!S.next(0, cur)) return;
    f32x4 acc[2][2][4][2];
#pragma unroll
    for (int a = 0; a < 2; ++a)
#pragma unroll
        for (int b = 0; b < 2; ++b)
#pragma unroll
            for (int m = 0; m < 4; ++m)
#pragma unroll
                for (int n = 0; n < 2; ++n) acc[a][b][m][n] = (f32x4){0.f, 0.f, 0.f, 0.f};
    bf16x8 At[4][2], B0[2][2], B1[2][2];
    const char* cA = (const char*)g.A + (size_t)cur.pm * tstep; const char* cB = (const char*)g.Bt + (size_t)cur.pn * tstep;
    S.a_ready(cur);
    if constexpr (SP2) {
        PG8_STAGE(PG8_SB(0, 0), cB, voffB); PG8_STAGE(PG8_SB(0, 1), cB + hstep, voffB); PG8_STAGE(PG8_SA(0, 0), cA, voffA); PG8_STAGE(PG8_SA(0, 1), cA + hstep, voffA);
        if (wr == 1) PG8_BAR;
        PG8_WAIT_V(2); PG8_BAR;
        PG8_STAGE(PG8_SB(1, 0), cB + kstep, voffB); PG8_STAGE(PG8_SA(1, 0), cA + kstep, voffA); PG8_STAGE(PG8_SB(1, 1), cB + hstep + kstep, voffB);
        PG8_WAIT_V(6); PG8_BAR;
    } else {
        PG8_STAGE(PG8_SB(0, 0), cB, voffB); PG8_STAGE(PG8_SA(0, 0), cA, voffA); PG8_STAGE(PG8_SB(0, 1), cB + hstep, voffB); PG8_STAGE(PG8_SA(0, 1), cA + hstep, voffA);
        if (wr == 1) PG8_BAR;
        PG8_WAIT_V(4); PG8_BAR;
        PG8_STAGE(PG8_SB(1, 0), cB + kstep, voffB); PG8_STAGE(PG8_SA(1, 0), cA + kstep, voffA); PG8_STAGE(PG8_SB(1, 1), cB + hstep + kstep, voffB);
        PG8_WAIT_V(6); PG8_BAR;
    }
    for (;;) {
        const bool has_next = S.next(ui + 1, nxt);
        const char* nA = has_next ? (const char*)g.A + (size_t)nxt.pm * tstep : cA; const char* nB = has_next ? (const char*)g.Bt + (size_t)nxt.pn * tstep : cB;
        for (int t = 0; t < nt; t += 2) {
            const bool last = (t == nt - 2);
            const char* a1 = cA + (size_t)(t + 1) * kstep;
            const char* a2 = last ? nA : cA + (size_t)(t + 2) * kstep; const char* b2 = last ? nB : cB + (size_t)(t + 2) * kstep;
            const char* a3 = a2 + kstep; const char* b3 = b2 + kstep;
            if (last && has_next) S.a_ready(nxt);
            if constexpr (SP2) {
            PG8_LDB(B0, 0, 0); PG8_LDB(B1, 0, 1); PG8_SCHED; PG8_LDA(At, 0, 0); PG8_STAGE(PG8_SA(1, 1), a1 + hstep, voffA);
            PG8_WAIT_V(8); PG8_WAIT_L(0); PG8_BAR; PG8_MMA(0, 0, At, B0); PG8_MMA(0, 1, At, B1); PG8_BAR; PG8_SCHED;
            PG8_LDA(At, 0, 1); PG8_STAGE(PG8_SB(0, 0), b2, voffB); PG8_STAGE(PG8_SB(0, 1), b2 + hstep, voffB); PG8_STAGE(PG8_SA(0, 0), a2, voffA);
            PG8_WAIT_V(8); PG8_WAIT_L(0); PG8_BAR; PG8_MMA(1, 0, At, B0); PG8_MMA(1, 1, At, B1); PG8_BAR; PG8_SCHED;
            PG8_LDB(B0, 1, 0); PG8_LDB(B1, 1, 1); PG8_SCHED; PG8_LDA(At, 1, 0); PG8_STAGE(PG8_SA(0, 1), a2 + hstep, voffA);
            PG8_WAIT_V(8); PG8_WAIT_L(0); PG8_BAR; PG8_MMA(0, 0, At, B0); PG8_MMA(0, 1, At, B1); PG8_BAR; PG8_SCHED;
            PG8_LDA(At, 1, 1); PG8_STAGE(PG8_SB(1, 0), b3, voffB); PG8_STAGE(PG8_SB(1, 1), b3 + hstep, voffB); PG8_STAGE(PG8_SA(1, 0), a3, voffA);
            PG8_WAIT_V(8); PG8_WAIT_L(0); PG8_BAR; PG8_MMA(1, 0, At, B0); PG8_MMA(1, 1, At, B1); PG8_BAR; PG8_SCHED;
            } else {
            PG8_LDB(B0, 0, 0); PG8_SCHED; PG8_LDA(At, 0, 0); PG8_STAGE(PG8_SA(1, 1), a1 + hstep, voffA);
            PG8_WAIT_L(8); PG8_BAR; PG8_WAIT_L(0); PG8_MMA(0, 0, At, B0); PG8_BAR; PG8_SCHED;
            PG8_LDB(B1, 0, 1); PG8_STAGE(PG8_SB(0, 0), b2, voffB);
            PG8_BAR; PG8_WAIT_L(0); PG8_MMA(0, 1, At, B1); PG8_BAR;
            PG8_LDA(At, 0, 1); PG8_STAGE(PG8_SA(0, 0), a2, voffA);
            PG8_BAR; PG8_WAIT_L(0); PG8_MMA(1, 0, At, B0); PG8_BAR; PG8_SCHED;
            PG8_STAGE(PG8_SB(0, 1), b2 + hstep, voffB);
            PG8_WAIT_V(6); PG8_BAR; PG8_MMA(1, 1, At, B1); PG8_BAR;
            PG8_LDB(B0, 1, 0); PG8_SCHED; PG8_LDA(At, 1, 0); PG8_STAGE(PG8_SA(0, 1), a2 + hstep, voffA);
            PG8_WAIT_L(8); PG8_BAR; PG8_WAIT_L(0); PG8_MMA(0, 0, At, B0); PG8_BAR; PG8_SCHED;
            PG8_LDB(B1, 1, 1); PG8_STAGE(PG8_SB(1, 0), b3, voffB);
            PG8_BAR; PG8_WAIT_L(0); PG8_MMA(0, 1, At, B1); PG8_BAR;
            PG8_LDA(At, 1, 1); PG8_STAGE(PG8_SA(1, 0), a3, voffA);
            PG8_BAR; PG8_WAIT_L(0); PG8_MMA(1, 0, At, B0); PG8_BAR; PG8_SCHED;
            PG8_STAGE(PG8_SB(1, 1), b3 + hstep, voffB);
            PG8_WAIT_V(6); PG8_BAR; PG8_MMA(1, 1, At, B1); PG8_BAR;
            }
        }
        if constexpr (ALIGN_EPI) { if (wr == 0) PG8_BAR; }
        if constexpr (!Epi::AFTER_DRAIN) { E(acc, cur, wr, wc, fr, fq); S.done(cur); }
        if (!has_next) break;
#pragma unroll
        for (int a = 0; a < 2; ++a)
#pragma unroll
            for (int b = 0; b < 2; ++b)
#pragma unroll
                for (int m = 0; m < 4; ++m)
#pragma unroll
                    for (int n = 0; n < 2; ++n) acc[a][b][m][n] = (f32x4){0.f, 0.f, 0.f, 0.f};
        cur = nxt; cA = nA; cB = nB; ++ui;
        if constexpr (ALIGN_EPI) { if (wr == 1) PG8_BAR; }
    }
    PG8_WAIT_V(0);
    if constexpr (!ALIGN_EPI) { if (wr == 0) PG8_BAR; }
    PG8_BAR;
    if constexpr (Epi::AFTER_DRAIN) { E.fused(acc, cur, wr, wc, fr, fq, lds, wid, lane); S.done(cur); }
#undef PG8_SA
#undef PG8_SB
#undef PG8_STAGE
#undef PG8_LDA
#undef PG8_LDB
#undef PG8_MMA
#undef PG8_WAIT_V
#undef PG8_WAIT_L
#undef PG8_BAR
#undef PG8_SCHED
}
}

#ifndef PG8_SP2
#define PG8_SP2 true
#endif
#ifndef PG8_ALIGN
#define PG8_ALIGN true
#endif
#ifndef MK_ONE_LAUNCH
#define MK_ONE_LAUNCH 0
#endif
constexpr int NWAVES = 8;
constexpr int BATCH = 2, T = 8192, D = 1024, FF = 4096, PLE = 256, M = BATCH * T;
constexpr int EVEN_IN = 1536, CHUNK = 128;
constexpr float LN_EPS = 1e-5f, ALPHA = 1.41421356237309515f;
constexpr int NPHASE = 17;

constexpr size_t MiB = 1u << 20;
constexpr size_t WS_CTL = 0, CTL_ZERO_BYTES = 1 * MiB;
constexpr size_t WS_WIN0 = 1 * MiB, WS_WOUT0 = 4 * MiB, WS_WIN1 = 6 * MiB, WS_WOUT1 = 12 * MiB, WS_W1 = 14 * MiB, WS_W2 = 30 * MiB, WS_WG = 46 * MiB, WS_WP = 50 * MiB;
constexpr size_t WS_POOLW = 51 * MiB, WS_SGUW = 51 * MiB + 128 * 1024;
constexpr size_t WS_XCH = 52 * MiB;
constexpr size_t WS_XBF = 54 * MiB;
constexpr size_t WS_PB = 86 * MiB;
constexpr size_t WS_BIG = 102 * MiB;
constexpr size_t WS_END = 230 * MiB;
constexpr size_t BIG_AUV = WS_BIG, BIG_Y = WS_BIG + 48 * MiB, BIG_H = WS_BIG, BIG_PP = WS_BIG, BIG_X3B = WS_BIG + 96 * MiB, BIG_Z = WS_BIG, BIG_BG = WS_BIG + 32 * MiB, BIG_YC = WS_BIG + 64 * MiB;
constexpr int CW_TMO = 0, CW_CODE = 1, CW_BAR = 4096, CW_SEAM = 16384, SEAM_BANK = 128 * 64;
constexpr int RING_OFF = 0, RING_BYTES = 131072;
constexpr int LDSCTL_OFF = RING_BYTES, MISC_OFF = LDSCTL_OFF + 320;
constexpr int LDS_BYTES = 147456;

#define GAS __attribute__((address_space(1)))
#define LAS __attribute__((address_space(3)))
typedef unsigned short bf16;
typedef unsigned v4u __attribute__((ext_vector_type(4)));
typedef unsigned v2u __attribute__((ext_vector_type(2)));
typedef float f32x4 __attribute__((ext_vector_type(4)));
typedef short bf16x8 __attribute__((ext_vector_type(8)));
typedef GAS unsigned gu32;
#define RLX_AGENT __ATOMIC_RELAXED, __HIP_MEMORY_SCOPE_AGENT
#define LDS_WAIT() asm volatile("s_waitcnt lgkmcnt(0)" ::: "memory")
#define VM_WAIT() asm volatile("s_waitcnt vmcnt(0)" ::: "memory")
__device__ __forceinline__ unsigned f2bf(float f) { unsigned u = __builtin_bit_cast(unsigned, f); return (u + 0x7fffu + ((u >> 16) & 1u)) >> 16; }
__device__ __forceinline__ unsigned pk2(float lo, float hi) { return f2bf(lo) | (f2bf(hi) << 16); }
__device__ __forceinline__ float blo(unsigned w) { return __uint_as_float(w << 16); }
__device__ __forceinline__ float bhi(unsigned w) { return __uint_as_float(w & 0xffff0000u); }
__device__ __forceinline__ float wave_sum(float v) {
#pragma unroll
    for (int o = 1; o < 64; o <<= 1) v += __shfl_xor(v, o);
    return v;
}

#define XB_TMO      128
#define XB_XCNT(j)  (256  + 64 * (j))
#define XB_XSUB(j)  (1280 + 64 * (j))
#define XB_XGEN(j)  (2304 + 64 * (j))
#define XB_TOP      3328
#define XB_TOPGEN   3392
#define XCD_BAR_WORDS 3456
#define XB_SPIN_CAP (1u << 18)

__device__ __forceinline__ unsigned xb_ld(unsigned* p)              { return __hip_atomic_load(p, __ATOMIC_RELAXED, __HIP_MEMORY_SCOPE_AGENT); }
__device__ __forceinline__ unsigned xb_add(unsigned* p, unsigned v) { return __hip_atomic_fetch_add(p, v, __ATOMIC_RELAXED, __HIP_MEMORY_SCOPE_AGENT); }
__device__ __forceinline__ unsigned xb_xcc_id() { return (unsigned)__builtin_amdgcn_s_getreg((3 << 11) | 20) & 0xFu; }
#define XB_SPIN(cond, bar) do { unsigned _sp = 0; while (cond) { __builtin_amdgcn_s_sleep(1); \
    if ((++_sp & 255u) == 0u) { if (xb_ld(&(bar)[XB_TMO])) break; if (_sp > XB_SPIN_CAP) { atomicAdd(&(bar)[XB_TMO], 1u); break; } } } } while (0)

struct XcdBarrier {
    unsigned* bar; unsigned x;
    volatile LAS unsigned* st;
};

__device__ __forceinline__ XcdBarrier xcd_barrier_post(unsigned* bar, volatile LAS unsigned* st) {
    XcdBarrier b; b.bar = bar; b.x = xb_xcc_id(); b.st = st;
    if (threadIdx.x == 0) (void)xb_add(&bar[XB_XCNT(b.x)], 1u);
    return b;
}
__device__ __forceinline__ void xcd_barrier_complete(unsigned* bar, unsigned x, unsigned& nloc, unsigned& nx) {
    const unsigned G = gridDim.x * gridDim.y * gridDim.z;
    unsigned sum, cnt, mine, sp = 0u;
    for (;;) {
        sum = 0u; cnt = 0u; mine = 0u;
#pragma unroll
        for (unsigned j = 0; j < 16; ++j) { const unsigned c = xb_ld(&bar[XB_XCNT(j)]); sum += c; cnt += (c > 0u) ? 1u : 0u; mine = (j == x) ? c : mine; }
        if (sum == G) break;
        __builtin_amdgcn_s_sleep(1);
        if ((++sp & 255u) == 0u) { if (xb_ld(&bar[XB_TMO])) break; if (sp > XB_SPIN_CAP) { atomicAdd(&bar[XB_TMO], 1u); break; } }
    }
    nloc = mine > 0u ? mine : 1u; nx = cnt > 0u ? cnt : 1u;
}

__device__ __forceinline__ void xcd_barrier(const XcdBarrier& b) {
    asm volatile("s_waitcnt vmcnt(0)" ::: "memory");
    __syncthreads();
    if (threadIdx.x == 0) {
        unsigned* bar = b.bar;
        __builtin_amdgcn_s_waitcnt(0);
        unsigned nloc = b.st[0], nx = b.st[1];
        if (nloc == 0u) { xcd_barrier_complete(bar, b.x, nloc, nx); b.st[0] = nloc; b.st[1] = nx; }
        const unsigned old = xb_add(&bar[XB_XSUB(b.x)], 1u);
        const unsigned gen = old / nloc;
        if (old + 1u == (gen + 1u) * nloc) {
            __builtin_amdgcn_fence(__ATOMIC_RELEASE, "agent");
            asm volatile("s_waitcnt vmcnt(0)" ::: "memory");
            const unsigned og = xb_add(&bar[XB_TOP], 1u);
            const unsigned tg = og / nx;
            if (og + 1u == (tg + 1u) * nx) xb_add(&bar[XB_TOPGEN], 1u);
            else XB_SPIN(xb_ld(&bar[XB_TOPGEN]) == tg, bar);
            __builtin_amdgcn_fence(__ATOMIC_ACQUIRE, "agent");
            xb_add(&bar[XB_XGEN(b.x)], 1u);
            asm volatile("s_waitcnt vmcnt(0)" ::: "memory");
        } else {
            XB_SPIN(xb_ld(&bar[XB_XGEN(b.x)]) == gen, bar);
            __builtin_amdgcn_fence(__ATOMIC_ACQUIRE, "agent");
            asm volatile("s_waitcnt vmcnt(0)" ::: "memory");
        }
    }
    __syncthreads();
}

struct Ctx {
    LAS unsigned char* lds;
    int tid, lane, wave, vcu, G;
    const float* in[21]; float* out; unsigned char* ws;
};
#define WSP(T_, off) ((T_*)(C.ws + (off)))

__device__ __forceinline__ void p0_transpose_item(const float* W, int K, int N, bf16* WT, int mode, LAS float* scr, int item, int lane) {
    const int nblk = N / 32, kb = item / nblk, nb = item % nblk, k0 = 64 * kb, n0 = 32 * nb;
    int d0 = n0;
    if (mode == 1) { if (n0 < 1024) d0 = 2048 + n0; else if (n0 < 2048) { const int ch = n0 - 1024; d0 = (ch >> 7) * 256 + (ch & 127); } else { const int ch = n0 - 2048; d0 = (ch >> 7) * 256 + 128 + (ch & 127); } }
#pragma unroll 8
    for (int i = 0; i < 32; ++i) { const int kk = 2 * i + (lane >> 5); scr[kk * 33 + (lane & 31)] = W[(size_t)(k0 + kk) * N + n0 + (lane & 31)]; }
    LDS_WAIT(); asm volatile("" ::: "memory");
    const int c = lane & 7;
#pragma unroll
    for (int j = 0; j < 4; ++j) { const int n = (lane >> 3) + 8 * j; const LAS float* s = scr + (8 * c) * 33 + n;
        v4u o; o.x = pk2(s[0 * 33], s[1 * 33]); o.y = pk2(s[2 * 33], s[3 * 33]); o.z = pk2(s[4 * 33], s[5 * 33]); o.w = pk2(s[6 * 33], s[7 * 33]);
        *(GAS v4u*)(WT + (size_t)(d0 + n) * K + k0 + 8 * c) = o; }
    LDS_WAIT(); asm volatile("" ::: "memory");
}
__device__ __forceinline__ void cvt8(const float* src, bf16* dst, size_t i) {
    const f32x4 a = *(const GAS f32x4*)(src + 8 * i), b = *(const GAS f32x4*)(src + 8 * i + 4);
    v4u o; o.x = pk2(a.x, a.y); o.y = pk2(a.z, a.w); o.z = pk2(b.x, b.y); o.w = pk2(b.z, b.w);
    *(GAS v4u*)(dst + 8 * i) = o;
}
__device__ __forceinline__ void p0_prologue(const Ctx& C) {
    LAS float* scr = (LAS float*)(C.lds + RING_OFF + C.wave * 16384);
    const int gw = C.vcu * NWAVES + C.wave, NGW = C.G * NWAVES;
    int total = 0;
    for (int it = gw;; it += NGW) {
        int r = it;
#define TR(src, K_, N_, dst, mode) { constexpr int ni = ((K_) / 64) * ((N_) / 32); if (r < ni) { p0_transpose_item((src), (K_), (N_), (dst), (mode), scr, r, C.lane); continue; } r -= ni; }
        TR(C.in[15], D, FF, WSP(bf16, WS_W1), 0)
        TR(C.in[15] + (size_t)D * FF, D, FF, WSP(bf16, WS_W1) + (size_t)D * FF, 0)
        TR(C.in[16], FF, D, WSP(bf16, WS_W2), 0)
        TR(C.in[16] + (size_t)D * FF, FF, D, WSP(bf16, WS_W2) + (size_t)D * FF, 0)
        TR(C.in[10], D, 3 * D, WSP(bf16, WS_WIN1), 1)
        TR(C.in[2], D, EVEN_IN, WSP(bf16, WS_WIN0), 0)
        TR(C.in[9], D, D, WSP(bf16, WS_WOUT0), 0)
        TR(C.in[12], D, D, WSP(bf16, WS_WOUT1), 0)
        TR(C.in[19], D, D, WSP(bf16, WS_WG), 0)
        TR(C.in[19] + (size_t)D * D, D, D, WSP(bf16, WS_WG) + (size_t)D * D, 0)
        TR(C.in[20], PLE, D, WSP(bf16, WS_WP), 0)
        TR(C.in[20] + (size_t)PLE * D, PLE, D, WSP(bf16, WS_WP) + (size_t)PLE * D, 0)
        TR(C.in[3], 128, 128, WSP(bf16, WS_POOLW), 0)
        TR(C.in[3] + 16384, 128, 128, WSP(bf16, WS_POOLW) + 16384, 0)
        TR(C.in[3] + 2 * 16384, 128, 128, WSP(bf16, WS_POOLW) + 2 * 16384, 0)
        TR(C.in[3] + 3 * 16384, 128, 128, WSP(bf16, WS_POOLW) + 3 * 16384, 0)
#undef TR
        break;
    }
    (void)total;
    const size_t gt = (size_t)C.vcu * (NWAVES * 64) + C.tid, NT = (size_t)C.G * (NWAVES * 64);
    for (size_t i = gt; i < (size_t)M * D / 8; i += NT) cvt8(C.in[0], WSP(bf16, WS_XBF), i);
    for (size_t i = gt; i < (size_t)2 * M * PLE / 8; i += NT) cvt8(C.in[1], WSP(bf16, WS_PB), i);
    for (size_t i = gt; i < (size_t)4 * 128 * 128 / 8; i += NT) {
        const int t = (int)(i >> 4) & 127, s8 = (int)(i & 15) * 8;
        const f32x4 a = *(const GAS f32x4*)(C.in[7] + 8 * i), b = *(const GAS f32x4*)(C.in[7] + 8 * i + 4);
        float v[8] = {a.x, a.y, a.z, a.w, b.x, b.y, b.z, b.w};
#pragma unroll
        for (int j = 0; j < 8; ++j) v[j] = (s8 + j <= t) ? v[j] : 0.f;
        v4u o; o.x = pk2(v[0], v[1]); o.y = pk2(v[2], v[3]); o.z = pk2(v[4], v[5]); o.w = pk2(v[6], v[7]);
        *(GAS v4u*)(WSP(bf16, WS_SGUW) + 8 * i) = o;
    }
}

__device__ __forceinline__ void ln_rows_phase(const Ctx& C, float* xf, bf16* xb, const float* g, const float* b) {
    const int gw = C.vcu * NWAVES + C.wave, NGW = C.G * NWAVES;
    f32x4 gv[4], bv[4];
#pragma unroll
    for (int j = 0; j < 4; ++j) { gv[j] = *(const GAS f32x4*)(g + 4 * C.lane + 256 * j); bv[j] = *(const GAS f32x4*)(b + 4 * C.lane + 256 * j); }
    for (int m = gw; m < M; m += NGW) {
        GAS f32x4* xr = (GAS f32x4*)(xf + (size_t)m * D) + C.lane;
        f32x4 v[4]; float s = 0.f;
#pragma unroll
        for (int j = 0; j < 4; ++j) { v[j] = xr[64 * j]; s += (v[j].x + v[j].y) + (v[j].z + v[j].w); }
        const float mean = wave_sum(s) * (1.f / D); float s2 = 0.f;
#pragma unroll
        for (int j = 0; j < 4; ++j) { v[j] = v[j] - mean; s2 += (v[j].x * v[j].x + v[j].y * v[j].y) + (v[j].z * v[j].z + v[j].w * v[j].w); }
        const float rstd = 1.f / sqrtf(wave_sum(s2) * (1.f / D) + LN_EPS);
        GAS v2u* o8 = (GAS v2u*)(xb + (size_t)m * D) + C.lane;
#pragma unroll
        for (int j = 0; j < 4; ++j) { const f32x4 o = v[j] * rstd * gv[j] + bv[j]; xr[64 * j] = o; v2u w; w.x = pk2(o.x, o.y); w.y = pk2(o.z, o.w); o8[64 * j] = w; }
    }
}

__device__ __forceinline__ int mx_off(int row, int chunk) { return row * 256 + ((chunk ^ (row & 15)) << 4); }
__device__ __forceinline__ void mixer_phase(const Ctx& C) {
    LAS unsigned char* LA = C.lds; LAS unsigned char* LB = C.lds + 32768; LAS float* ST = (LAS float*)(C.lds + 65536);
    const bf16* AUV = WSP(bf16, BIG_AUV); bf16* Y = WSP(bf16, BIG_Y);
    const int tid = C.tid, lane = C.lane, wave = C.wave, fr = lane & 15, fq = lane >> 4;
    for (int u = blockIdx.x; u < (M / CHUNK) * 8; u += C.G) {
        const int chunk = u >> 3, part = ((u & 7) + 4 * (u >> 8)) & 7, t0 = chunk * CHUNK;
        const bf16* Bsrc;
        if (part < 4) {
            const int g = part, w = 2 << g, tb = t0 & (T - 1), cl = tid & 15, rr = tid >> 4;
            const float inv_w = 1.0f / (float)w;
#pragma unroll 1
            for (int pass = 0; pass < 4; ++pass) {
                const int t = pass * 32 + rr, tt = tb + t;
                const bf16* ap = AUV + (size_t)(t0 + t) * EVEN_IN + g * 128 + cl * 8;
                const v4u a0 = *(const GAS v4u*)ap;
                float x0[8] = {blo(a0.x), bhi(a0.x), blo(a0.y), bhi(a0.y), blo(a0.z), bhi(a0.z), blo(a0.w), bhi(a0.w)};
                float s[8];
#pragma unroll
                for (int j = 0; j < 8; ++j) s[j] = x0[j];
                for (int k = 1; k < w; ++k) if (tt - k >= 0) {
                    const v4u a = *(const GAS v4u*)(ap - (size_t)k * EVEN_IN);
                    s[0] += blo(a.x); s[1] += bhi(a.x); s[2] += blo(a.y); s[3] += bhi(a.y); s[4] += blo(a.z); s[5] += bhi(a.z); s[6] += blo(a.w); s[7] += bhi(a.w);
                }
                const float ic = (tt + 1 >= w) ? inv_w : 1.0f / (float)(tt + 1);
                v4u o; o.x = pk2(s[0] * ic - x0[0], s[1] * ic - x0[1]); o.y = pk2(s[2] * ic - x0[2], s[3] * ic - x0[3]); o.z = pk2(s[4] * ic - x0[4], s[5] * ic - x0[5]); o.w = pk2(s[6] * ic - x0[6], s[7] * ic - x0[7]);
                *(LAS v4u*)(LA + mx_off(t, cl)) = o;
            }
            Bsrc = WSP(bf16, WS_POOLW) + g * 16384;
#pragma unroll
            for (int j = 0; j < 4; ++j) { const int idx = tid + 512 * j, row = idx >> 4, cc = idx & 15; *(LAS v4u*)(LB + mx_off(row, cc)) = *(const GAS v4u*)(Bsrc + row * 128 + cc * 8); }
        } else {
            const int h = part - 4;
#pragma unroll 4
            for (int r = 0; r < 16; ++r) { const int row = wave * 16 + r;
                const v4u a = *(const GAS v4u*)(AUV + (size_t)(t0 + row) * EVEN_IN + 1024 + lane * 8);
                float x[8] = {blo(a.x), bhi(a.x), blo(a.y), bhi(a.y), blo(a.z), bhi(a.z), blo(a.w), bhi(a.w)};
                float s = ((x[0] + x[1]) + (x[2] + x[3])) + ((x[4] + x[5]) + (x[6] + x[7]));
                const float mean = wave_sum(s) * (1.f / 512.f); float q = 0.f;
#pragma unroll
                for (int j = 0; j < 8; ++j) { const float d = x[j] - mean; q += d * d; }
                const float rstd = 1.f / sqrtf(wave_sum(q) * (1.f / 512.f) + LN_EPS);
                if (lane == 0) { ST[2 * row] = mean; ST[2 * row + 1] = rstd; }
            }
            Bsrc = WSP(bf16, WS_SGUW) + h * 16384;
#pragma unroll
            for (int j = 0; j < 4; ++j) { const int idx = tid + 512 * j, row = idx >> 4, cc = idx & 15; *(LAS v4u*)(LA + mx_off(row, cc)) = *(const GAS v4u*)(Bsrc + row * 128 + cc * 8); }
            LDS_WAIT(); __syncthreads();
            const int c = tid & 127, sg = tid >> 7;
            const float gg = C.in[5][h * 128 + c], bb = C.in[6][h * 128 + c];
            const bf16* vp = AUV + (size_t)t0 * EVEN_IN + 1024 + h * 128 + c;
#pragma unroll 1
            for (int q4 = 0; q4 < 4; ++q4) { const int s0 = sg * 32 + q4 * 8; float y[8];
#pragma unroll
                for (int j = 0; j < 8; ++j) { const float xv = __uint_as_float((unsigned)(*(const GAS bf16*)(vp + (size_t)(s0 + j) * EVEN_IN)) << 16); y[j] = (xv - ST[2 * (s0 + j)]) * ST[2 * (s0 + j) + 1] * gg + bb; }
                v4u o; o.x = pk2(y[0], y[1]); o.y = pk2(y[2], y[3]); o.z = pk2(y[4], y[5]); o.w = pk2(y[6], y[7]);
                *(LAS v4u*)(LB + mx_off(c, s0 >> 3)) = o;
            }
        }
        LDS_WAIT(); __syncthreads();
        bf16x8 af[4]; f32x4 acc[8];
#pragma unroll
        for (int ks = 0; ks < 4; ++ks) af[ks] = *(const LAS bf16x8*)(LA + mx_off(wave * 16 + fr, 4 * ks + fq));
#pragma unroll
        for (int nt = 0; nt < 8; ++nt) { acc[nt] = (f32x4){0.f, 0.f, 0.f, 0.f};
#pragma unroll
            for (int ks = 0; ks < 4; ++ks) { const bf16x8 bfr = *(const LAS bf16x8*)(LB + mx_off(nt * 16 + fr, 4 * ks + fq)); acc[nt] = __builtin_amdgcn_mfma_f32_16x16x32_bf16(bfr, af[ks], acc[nt], 0, 0, 0); } }
        const int t = wave * 16 + fr;
        if (part < 4) {
            const int g = part;
#pragma unroll
            for (int nt = 0; nt < 8; ++nt) { const int d = nt * 16 + 4 * fq; const f32x4 sc = *(const GAS f32x4*)(C.in[4] + g * 128 + d); const f32x4 o = acc[nt] * sc;
                v2u wv; wv.x = pk2(o.x, o.y); wv.y = pk2(o.z, o.w); *(GAS v2u*)(Y + (size_t)(t0 + t) * D + g * 128 + d) = wv; }
        } else {
            const int h = part - 4; const float bs = C.in[8][h * 128 + t];
#pragma unroll
            for (int nt = 0; nt < 8; ++nt) { const int c = nt * 16 + 4 * fq; const v2u uu = *(const GAS v2u*)(AUV + (size_t)(t0 + t) * EVEN_IN + 512 + h * 128 + c);
                f32x4 o; o.x = blo(uu.x) * (acc[nt].x + bs); o.y = bhi(uu.x) * (acc[nt].y + bs); o.z = blo(uu.y) * (acc[nt].z + bs); o.w = bhi(uu.y) * (acc[nt].w + bs);
                v2u wv; wv.x = pk2(o.x, o.y); wv.y = pk2(o.z, o.w); *(GAS v2u*)(Y + (size_t)(t0 + t) * D + 512 + h * 128 + c) = wv; }
        }
        LDS_WAIT(); __syncthreads();
    }
}

__device__ __forceinline__ void conv_phase(const Ctx& C) {
    const bf16* Z = WSP(bf16, BIG_Z); const bf16* Bg = WSP(bf16, BIG_BG); bf16* Yc = WSP(bf16, BIG_YC);
    const float* cw = C.in[11];
    for (int it = C.vcu * (NWAVES * 64) + C.tid; it < (M / 16) * (D / 8); it += C.G * NWAVES * 64) {
        const int c8 = it & 127, rb = it >> 7, r0 = rb * 16, tb = r0 & (T - 1);
        float w0[8], w1[8], w2[8];
#pragma unroll
        for (int j = 0; j < 8; ++j) { w0[j] = cw[c8 * 8 + j]; w1[j] = cw[D + c8 * 8 + j]; w2[j] = cw[2 * D + c8 * 8 + j]; }
        const bf16* zp = Z + (size_t)r0 * D + c8 * 8;
        v4u zm2 = (v4u){0u, 0u, 0u, 0u}, zm1 = (v4u){0u, 0u, 0u, 0u};
        if (tb >= 2) { zm2 = *(const GAS v4u*)(zp - 2 * D); zm1 = *(const GAS v4u*)(zp - D); }
#pragma unroll 4
        for (int r = 0; r < 16; ++r) {
            const v4u z = *(const GAS v4u*)(zp + (size_t)r * D), b = *(const GAS v4u*)(Bg + (size_t)(r0 + r) * D + c8 * 8);
            float o[8];
            o[0] = blo(b.x) * (w0[0] * blo(zm2.x) + w1[0] * blo(zm1.x) + w2[0] * blo(z.x)); o[1] = bhi(b.x) * (w0[1] * bhi(zm2.x) + w1[1] * bhi(zm1.x) + w2[1] * bhi(z.x));
            o[2] = blo(b.y) * (w0[2] * blo(zm2.y) + w1[2] * blo(zm1.y) + w2[2] * blo(z.y)); o[3] = bhi(b.y) * (w0[3] * bhi(zm2.y) + w1[3] * bhi(zm1.y) + w2[3] * bhi(z.y));
            o[4] = blo(b.z) * (w0[4] * blo(zm2.z) + w1[4] * blo(zm1.z) + w2[4] * blo(z.z)); o[5] = bhi(b.z) * (w0[5] * bhi(zm2.z) + w1[5] * bhi(zm1.z) + w2[5] * bhi(z.z));
            o[6] = blo(b.w) * (w0[6] * blo(zm2.w) + w1[6] * blo(zm1.w) + w2[6] * blo(z.w)); o[7] = bhi(b.w) * (w0[7] * bhi(zm2.w) + w1[7] * bhi(zm1.w) + w2[7] * bhi(z.w));
            v4u ov; ov.x = pk2(o[0], o[1]); ov.y = pk2(o[2], o[3]); ov.z = pk2(o[4], o[5]); ov.w = pk2(o[6], o[7]);
            *(GAS v4u*)(Yc + (size_t)(r0 + r) * D + c8 * 8) = ov;
            zm2 = zm1; zm1 = z;
        }
    }
}

struct Args { const float* in[21]; float* out; unsigned char* ws; int ph_lo, ph_hi; };
__global__ void __launch_bounds__(NWAVES * 64, 2) trunk_fwd(Args args) {
    extern __shared__ __attribute__((aligned(16))) unsigned char lds[];
    Ctx C;
    C.lds = (LAS unsigned char*)lds;
    C.tid = threadIdx.x; C.lane = C.tid & 63; C.wave = __builtin_amdgcn_readfirstlane(C.tid >> 6);
    C.G = gridDim.x; { const int bx = blockIdx.x; C.vcu = (C.G % 8 == 0) ? (bx % 8) * (C.G / 8) + bx / 8 : bx; }
#pragma unroll
    for (int i = 0; i < 21; ++i) C.in[i] = args.in[i];
    C.out = args.out; C.ws = args.ws;
    volatile LAS unsigned* MISC = (volatile LAS unsigned*)(C.lds + MISC_OFF);
    gu32* ctl = (gu32*)(args.ws + WS_CTL);
    for (int u = C.tid; u < (LDS_BYTES - LDSCTL_OFF) / 4; u += NWAVES * 64) ((LAS unsigned*)(C.lds + LDSCTL_OFF))[u] = 0u;
    __syncthreads();
#if MK_ONE_LAUNCH
    XcdBarrier bar = xcd_barrier_post((unsigned*)(ctl + CW_BAR), MISC + 8);
#define GRID_BAR() xcd_barrier(bar)
#else
    (void)MISC; (void)ctl;
#define GRID_BAR() do {} while (0)
#endif
    const int lo = args.ph_lo, hi = args.ph_hi;
#define IN(k) (lo <= (k) && (k) < hi)
#define SEAM(k) do { if (IN(k) && IN((k) + 1)) GRID_BAR(); } while (0)
    float* XF = C.out;
    bf16* XBF = WSP(bf16, WS_XBF);

    if (IN(0)) { p0_prologue(C); } SEAM(0);
    if (IN(1)) { pg8::Gemm g{XBF, WSP(bf16, WS_WIN0), M, EVEN_IN, D}; pg8::StaticOrder S; S.init(M, EVEN_IN, C.G, (int)blockIdx.x);
        pg8::EpiBf16<0> E{WSP(bf16, BIG_AUV), EVEN_IN};
        pg8::gemm_phase<pg8::EpiBf16<0>, pg8::StaticOrder, PG8_ALIGN, PG8_SP2>(C.lds + RING_OFF, g, S, E); } SEAM(1);
    if (IN(2)) { mixer_phase(C); } SEAM(2);
    if (IN(3)) { pg8::Gemm g{WSP(bf16, BIG_Y), WSP(bf16, WS_WOUT0), M, D, D}; pg8::StaticOrder S; S.init(M, D, C.G, (int)blockIdx.x);
        pg8::EpiRes E{C.in[0], XF, D, ALPHA};
        pg8::gemm_phase<pg8::EpiRes, pg8::StaticOrder, PG8_ALIGN, PG8_SP2>(C.lds + RING_OFF, g, S, E); } SEAM(3);
    if (IN(4)) { ln_rows_phase(C, XF, XBF, C.in[13], C.in[14]); } SEAM(4);
    if (IN(5)) { pg8::Gemm g{XBF, WSP(bf16, WS_W1), M, FF, D}; pg8::StaticOrder S; S.init(M, FF, C.G, (int)blockIdx.x);
        pg8::EpiBf16<2> E{WSP(bf16, BIG_H), FF};
        pg8::gemm_phase<pg8::EpiBf16<2>, pg8::StaticOrder, PG8_ALIGN, PG8_SP2>(C.lds + RING_OFF, g, S, E); } SEAM(5);
    if (IN(6)) { pg8::Gemm g{WSP(bf16, BIG_H), WSP(bf16, WS_W2), M, D, FF}; pg8::StaticOrder S; S.init(M, D, C.G, (int)blockIdx.x);
        pg8::EpiRes E{XF, XF, D, ALPHA};
        pg8::gemm_phase<pg8::EpiRes, pg8::StaticOrder, PG8_ALIGN, PG8_SP2>(C.lds + RING_OFF, g, S, E); } SEAM(6);
    if (IN(7)) { ln_rows_phase(C, XF, XBF, C.in[17], C.in[18]);
        pg8::Gemm g{WSP(bf16, WS_PB), WSP(bf16, WS_WP), M, D, PLE}; pg8::StaticOrder S; S.init(M, D, C.G, (int)blockIdx.x);
        pg8::EpiBf16<0> E{WSP(bf16, BIG_PP), D};
        pg8::gemm_phase<pg8::EpiBf16<0>, pg8::StaticOrder, PG8_ALIGN, PG8_SP2>(C.lds + RING_OFF, g, S, E); } SEAM(7);
    if (IN(8)) { pg8::Gemm g{XBF, WSP(bf16, WS_WG), M, D, D}; pg8::StaticOrder S; S.init(M, D, C.G, (int)blockIdx.x);
        pg8::EpiGate E{XF, WSP(bf16, BIG_PP), XF, WSP(bf16, BIG_X3B), D};
        pg8::gemm_phase<pg8::EpiGate, pg8::StaticOrder, PG8_ALIGN, PG8_SP2>(C.lds + RING_OFF, g, S, E); } SEAM(8);
    if (IN(9)) { pg8::Gemm g{WSP(bf16, BIG_X3B), WSP(bf16, WS_WIN1), M, 3 * D, D}; pg8::StaticOrder S; S.init(M, 3 * D, C.G, (int)blockIdx.x);
        pg8::EpiCH E{WSP(bf16, BIG_Z), WSP(bf16, BIG_BG), D};
        pg8::gemm_phase<pg8::EpiCH, pg8::StaticOrder, PG8_ALIGN, PG8_SP2>(C.lds + RING_OFF, g, S, E); } SEAM(9);
    if (IN(10)) { conv_phase(C); } SEAM(10);
    if (IN(11)) { pg8::Gemm g{WSP(bf16, BIG_YC), WSP(bf16, WS_WOUT1), M, D, D}; pg8::StaticOrder S; S.init(M, D, C.G, (int)blockIdx.x);
        pg8::EpiRes E{XF, XF, D, ALPHA};
        pg8::gemm_phase<pg8::EpiRes, pg8::StaticOrder, PG8_ALIGN, PG8_SP2>(C.lds + RING_OFF, g, S, E); } SEAM(11);
    if (IN(12)) { ln_rows_phase(C, XF, XBF, C.in[13] + D, C.in[14] + D); } SEAM(12);
    if (IN(13)) { pg8::Gemm g{XBF, WSP(bf16, WS_W1) + (size_t)D * FF, M, FF, D}; pg8::StaticOrder S; S.init(M, FF, C.G, (int)blockIdx.x);
        pg8::EpiBf16<2> E{WSP(bf16, BIG_H), FF};
        pg8::gemm_phase<pg8::EpiBf16<2>, pg8::StaticOrder, PG8_ALIGN, PG8_SP2>(C.lds + RING_OFF, g, S, E); } SEAM(13);
    if (IN(14)) { pg8::Gemm g{WSP(bf16, BIG_H), WSP(bf16, WS_W2) + (size_t)D * FF, M, D, FF}; pg8::StaticOrder S; S.init(M, D, C.G, (int)blockIdx.x);
        pg8::EpiRes E{XF, XF, D, ALPHA};
        pg8::gemm_phase<pg8::EpiRes, pg8::StaticOrder, PG8_ALIGN, PG8_SP2>(C.lds + RING_OFF, g, S, E); } SEAM(14);
    if (IN(15)) { ln_rows_phase(C, XF, XBF, C.in[17] + D, C.in[18] + D);
        pg8::Gemm g{WSP(bf16, WS_PB) + (size_t)M * PLE, WSP(bf16, WS_WP) + (size_t)PLE * D, M, D, PLE}; pg8::StaticOrder S; S.init(M, D, C.G, (int)blockIdx.x);
        pg8::EpiBf16<0> E{WSP(bf16, BIG_PP), D};
        pg8::gemm_phase<pg8::EpiBf16<0>, pg8::StaticOrder, PG8_ALIGN, PG8_SP2>(C.lds + RING_OFF, g, S, E); } SEAM(15);
    if (IN(16)) { pg8::Gemm g{XBF, WSP(bf16, WS_WG) + (size_t)D * D, M, D, D}; pg8::StaticOrder S; S.init(M, D, C.G, (int)blockIdx.x);
        pg8::EpiGate E{XF, WSP(bf16, BIG_PP), XF, nullptr, D};
        pg8::gemm_phase<pg8::EpiGate, pg8::StaticOrder, PG8_ALIGN, PG8_SP2>(C.lds + RING_OFF, g, S, E); }
#undef IN
#undef SEAM
}

extern "C" void kernel_launch(void* const* d_in, const int* in_sizes, int n_in, void* d_out, int out_size, void* d_ws, size_t ws_size, hipStream_t stream) {
    static int grid = 0;
    if (grid == 0) {
        if (n_in != 21 || in_sizes[0] != M * D || out_size != M * D || ws_size < WS_END) { fprintf(stderr, "kernel_launch: unexpected shapes (n_in %d, in0 %d, out %d, ws %zu); nothing launched\n", n_in, n_in > 0 ? in_sizes[0] : -1, out_size, ws_size); grid = -1; return; }
        int dev = 0, cus = 0, per_cu = 0;
        if (hipGetDevice(&dev) != hipSuccess || hipDeviceGetAttribute(&cus, hipDeviceAttributeMultiprocessorCount, dev) != hipSuccess) { grid = -1; return; }
        if (hipFuncSetAttribute((const void*)trunk_fwd, hipFuncAttributeMaxDynamicSharedMemorySize, LDS_BYTES) != hipSuccess) { fprintf(stderr, "kernel_launch: hipFuncSetAttribute failed\n"); grid = -1; return; }
        if (hipOccupancyMaxActiveBlocksPerMultiprocessor(&per_cu, (const void*)trunk_fwd, NWAVES * 64, LDS_BYTES) != hipSuccess || per_cu < 1) { fprintf(stderr, "kernel_launch: occupancy query says %d blocks per CU\n", per_cu); grid = -1; (void)hipGetLastError(); return; }
        grid = cus;
    }
    if (grid < 0) return;
    Args a{};
    for (int i = 0; i < 21; ++i) a.in[i] = (const float*)d_in[i];
    a.out = (float*)d_out; a.ws = (unsigned char*)d_ws;
#if MK_ONE_LAUNCH
    if (hipMemsetAsync((char*)d_ws + WS_CTL, 0, CTL_ZERO_BYTES, stream) != hipSuccess) { fprintf(stderr, "kernel_launch: memset failed\n"); return; }
    a.ph_lo = 0; a.ph_hi = NPHASE;
    void* kargs[] = {&a};
    hipError_t le = hipLaunchCooperativeKernel((const void*)trunk_fwd, dim3(grid), dim3(NWAVES * 64), kargs, LDS_BYTES, stream);
    if (le != hipSuccess) fprintf(stderr, "kernel_launch: cooperative launch failed: %s (grid %d)\n", hipGetErrorName(le), grid);
#else
    for (int li = 0; li < NPHASE; ++li) {
        a.ph_lo = li; a.ph_hi = li + 1;
        hipLaunchKernelGGL(trunk_fwd, dim3(grid), dim3(NWAVES * 64), LDS_BYTES, stream, a);
        const hipError_t le = hipPeekAtLastError();
        if (le != hipSuccess) { fprintf(stderr, "kernel_launch: launch %d failed: %s\n", li, hipGetErrorName(le)); break; }
    }
#endif
}
```
